# Optimizing an MI355X kernel written in HIP

```python
import math
import jax
import jax.numpy as jnp
from jax import lax
import numpy as np


D_MODEL = 1024
BATCH = 4
SEQ = 4096
DEPTH = 2

A_HEADS = 8
A_HEAD_DIM = 64
A_WIDTH = A_HEADS * A_HEAD_DIM
MOBA_BLOCK = 256
MOBA_TOPK = 3
MOBA_Q_CHUNK = 64
REL_BUCKETS = 32
REL_MAX_DIST = 128
S5_WIDTH = D_MODEL - A_WIDTH
S5_GROUP = 16
S5_GROUPS = S5_WIDTH // S5_GROUP
S5_STATE = 64
C_HEADS = 8
C_HEAD_DIM = D_MODEL // C_HEADS
C_WIDTH = C_HEADS * C_HEAD_DIM
C_CONV = 4
C_CHUNK = 64
D_FF = 4 * D_MODEL
N_EVEN = (DEPTH + 1) // 2
N_ODD = DEPTH // 2
DN_ALPHA = (2 * DEPTH) ** 0.25
DN_BETA = (8 * DEPTH) ** -0.25
LN_EPS = 1e-5
RMS_EPS = 1e-6
L2_EPS = 1e-6
NEG_INF = -1e30

kernel_name = 'moba_s5_gated_deltanet_deepnorm_hybrid'


def _layer_norm(x, g, b):
    xf = x.astype(jnp.float32)
    mu = jnp.mean(xf, axis=-1, keepdims=True)
    var = jnp.mean(jnp.square(xf - mu), axis=-1, keepdims=True)
    y = (xf - mu) * lax.rsqrt(var + LN_EPS) * g.astype(jnp.float32) + b.astype(jnp.float32)
    return y.astype(x.dtype)


def _t5_bucket(dist):
    max_exact = REL_BUCKETS // 2
    n = jnp.maximum(dist, 0)
    nf = jnp.maximum(n, 1).astype(jnp.float32)
    large = max_exact + (jnp.log(nf / max_exact) / math.log(REL_MAX_DIST / max_exact)
                         * (REL_BUCKETS - max_exact)).astype(jnp.int32)
    large = jnp.minimum(large, REL_BUCKETS - 1)
    return jnp.where(n < max_exact, n, large)


def _moba_attention(q, k, v, rel_table):
    b, s, h, d = q.shape
    nb = -(-s // MOBA_BLOCK)
    s_pad = nb * MOBA_BLOCK
    pad = ((0, 0), (0, 0), (0, s_pad - s), (0, 0))
    q = q.transpose(0, 2, 1, 3) * (d ** -0.5)
    k_blocks = jnp.pad(k.transpose(0, 2, 1, 3), pad).reshape(b, h, nb, MOBA_BLOCK, d)
    v_blocks = jnp.pad(v.transpose(0, 2, 1, 3), pad).reshape(b, h, nb, MOBA_BLOCK, d)
    k_mean = jnp.mean(k_blocks, axis=3)
    gate = jnp.einsum('bhsd,bhnd->bhsn', q, k_mean).astype(jnp.float32)
    q_blk = jnp.arange(s) // MOBA_BLOCK
    past = jnp.arange(nb)[None, :] < q_blk[:, None]
    gate = jnp.where(past, gate, NEG_INF)
    n_sel = min(MOBA_TOPK, nb)
    _, sel = lax.top_k(gate, n_sel)

    qc = MOBA_Q_CHUNK
    nc = s // qc
    q_ch = q.reshape(b, h, nc, qc, d).transpose(2, 0, 1, 3, 4)
    sel_ch = sel.reshape(b, h, nc, qc, n_sel).transpose(2, 0, 1, 3, 4)
    b_idx = jnp.arange(b)[:, None, None, None]
    h_idx = jnp.arange(h)[None, :, None, None]
    h_idx5 = jnp.arange(h)[None, :, None, None, None]
    table_t = rel_table.T
    offs = jnp.arange(MOBA_BLOCK)

    def chunk_attn(args):
        c, q_c, sel_c = args
        q_pos = c * qc + jnp.arange(qc)
        blk = (c * qc) // MOBA_BLOCK
        k_own = lax.dynamic_index_in_dim(k_blocks, blk, axis=2, keepdims=False)
        v_own = lax.dynamic_index_in_dim(v_blocks, blk, axis=2, keepdims=False)
        dist_own = q_pos[:, None] - (blk * MOBA_BLOCK + offs)[None, :]
        logit_own = (jnp.einsum('bhqd,bhkd->bhqk', q_c, k_own).astype(jnp.float32)
                     + table_t[:, _t5_bucket(dist_own)][None].astype(jnp.float32))
        logit_own = jnp.where(dist_own >= 0, logit_own, NEG_INF)
        k_sel = k_blocks[b_idx, h_idx, sel_c]
        v_sel = v_blocks[b_idx, h_idx, sel_c]
        dist_sel = q_pos[None, None, :, None, None] - (sel_c[..., None] * MOBA_BLOCK + offs)
        logit_sel = (jnp.einsum('bhqd,bhqnkd->bhqnk', q_c, k_sel).astype(jnp.float32)
                     + table_t[h_idx5, _t5_bucket(dist_sel)].astype(jnp.float32))
        valid = (sel_c < blk)[..., None]
        logit_sel = jnp.where(valid, logit_sel, NEG_INF)
        logits = jnp.concatenate([logit_own, logit_sel.reshape(b, h, qc, n_sel * MOBA_BLOCK)], axis=-1)
        p = jax.nn.softmax(logits, axis=-1).astype(v_blocks.dtype)
        p_own = p[..., :MOBA_BLOCK]
        p_sel = p[..., MOBA_BLOCK:].reshape(b, h, qc, n_sel, MOBA_BLOCK)
        return (jnp.einsum('bhqk,bhkd->bhqd', p_own, v_own)
                + jnp.einsum('bhqnk,bhqnkd->bhqd', p_sel, v_sel))

    out = lax.map(chunk_attn, (jnp.arange(nc), q_ch, sel_ch))
    return out.transpose(1, 0, 3, 2, 4).reshape(b, s, h * d)


def _complex_linear_combine(e1, e2):
    a1r, a1i, b1r, b1i = e1
    a2r, a2i, b2r, b2i = e2
    ar = a2r * a1r - a2i * a1i
    ai = a2r * a1i + a2i * a1r
    br = a2r * b1r - a2i * b1i + b2r
    bi = a2r * b1i + a2i * b1r + b2i
    return (ar, ai, br, bi)


def _s5_mixer(u, lam_re, lam_im, b_re, b_im, c_re, c_im, d_skip, log_dt, w_glu, b_glu):
    f32 = jnp.float32
    bsz, s, _ = u.shape
    uf = u.astype(f32)
    ug = uf.reshape(bsz, s, S5_GROUPS, S5_GROUP)
    lr = jnp.minimum(lam_re.astype(f32), -1e-4)
    li = lam_im.astype(f32)
    dt = jnp.exp(log_dt.astype(f32))[:, None]
    mag = jnp.exp(lr * dt)
    a_re = mag * jnp.cos(li * dt)
    a_im = mag * jnp.sin(li * dt)
    den = lr * lr + li * li
    coef_re = ((a_re - 1.0) * lr + a_im * li) / den
    coef_im = (a_im * lr - (a_re - 1.0) * li) / den
    br = b_re.astype(f32)
    bi = b_im.astype(f32)
    bb_re = coef_re[..., None] * br - coef_im[..., None] * bi
    bb_im = coef_re[..., None] * bi + coef_im[..., None] * br
    x_re = jnp.einsum('gph,bsgh->sbgp', bb_re, ug)
    x_im = jnp.einsum('gph,bsgh->sbgp', bb_im, ug)
    a_re_t = jnp.broadcast_to(a_re[None, None], (s, 1) + a_re.shape)
    a_im_t = jnp.broadcast_to(a_im[None, None], (s, 1) + a_im.shape)
    _, _, h_re, h_im = lax.associative_scan(_complex_linear_combine,
                                            (a_re_t, a_im_t, x_re, x_im), axis=0)
    y = (jnp.einsum('ghp,sbgp->bsgh', c_re.astype(f32), h_re)
         - jnp.einsum('ghp,sbgp->bsgh', c_im.astype(f32), h_im))
    y = y.reshape(bsz, s, S5_WIDTH) + d_skip.astype(f32) * uf
    g = jax.nn.gelu(y)
    out = g * jax.nn.sigmoid(g @ w_glu.astype(f32) + b_glu.astype(f32))
    return out.astype(u.dtype)


def _causal_depthwise_conv(x, w):
    kw = w.shape[0]
    return lax.conv_general_dilated(x, w[:, None, :].astype(x.dtype), window_strides=(1,),
                                    padding=[(kw - 1, 0)],
                                    dimension_numbers=('NWC', 'WIO', 'NWC'),
                                    feature_group_count=x.shape[-1])


def _l2norm(t):
    return t * lax.rsqrt(jnp.sum(t * t, axis=-1, keepdims=True) + L2_EPS)


def _gated_delta_rule(q, k, v, g, beta):
    b, s, h, dk = q.shape
    dv = v.shape[-1]
    c = C_CHUNK
    n = s // c

    def chunks(t):
        return t.reshape(b, n, c, h, -1).transpose(0, 3, 1, 2, 4)

    q = chunks(q) * (dk ** -0.5)
    k = chunks(k)
    v = chunks(v)
    beta = beta.reshape(b, n, c, h).transpose(0, 3, 1, 2)
    g = jnp.cumsum(g.reshape(b, n, c, h).transpose(0, 3, 1, 2), axis=-1)
    tril_incl = jnp.tril(jnp.ones((c, c), bool))
    tril_strict = jnp.tril(jnp.ones((c, c), bool), -1)
    diff = g[..., :, None] - g[..., None, :]
    decay = jnp.where(tril_incl, jnp.exp(jnp.where(tril_incl, diff, 0.0)), 0.0)
    k_beta = k * beta[..., None]
    v_beta = v * beta[..., None]
    lower = jnp.where(tril_strict, jnp.einsum('bhnid,bhnjd->bhnij', k_beta, k) * decay, 0.0)
    a_mat = lower + jnp.eye(c, dtype=jnp.float32)
    u = lax.linalg.triangular_solve(a_mat, v_beta, left_side=True, lower=True, unit_diagonal=True)
    w = lax.linalg.triangular_solve(a_mat, k_beta * jnp.exp(g)[..., None], left_side=True,
                                    lower=True, unit_diagonal=True)
    intra = jnp.einsum('bhnid,bhnjd->bhnij', q, k) * decay
    g_last = g[..., -1]
    q_dec = q * jnp.exp(g)[..., None]
    k_dec = k * jnp.exp(g_last[..., None] - g)[..., None]

    def step(state, xs):
        q_i, k_i, u_i, w_i, a_i, gl_i = xs
        v_new = u_i - jnp.einsum('bhcd,bhde->bhce', w_i, state)
        o = jnp.einsum('bhcd,bhde->bhce', q_i, state) + jnp.einsum('bhij,bhje->bhie', a_i, v_new)
        state = state * jnp.exp(gl_i)[..., None, None] + jnp.einsum('bhcd,bhce->bhde', k_i, v_new)
        return state, o

    xs = (jnp.moveaxis(q_dec, 2, 0), jnp.moveaxis(k_dec, 2, 0), jnp.moveaxis(u, 2, 0),
          jnp.moveaxis(w, 2, 0), jnp.moveaxis(intra, 2, 0), jnp.moveaxis(g_last, 2, 0))
    state0 = jnp.zeros((b, h, dk, dv), jnp.float32)
    _, o = lax.scan(step, state0, xs)
    return o.transpose(1, 0, 3, 2, 4).reshape(b, s, h, dv)


def _gdn_mixer(hp, conv_w, a_log, dt_bias, norm_w):
    f32 = jnp.float32
    bsz, s, _ = hp.shape
    qkv = jax.nn.silu(_causal_depthwise_conv(hp[..., :3 * C_WIDTH], conv_w)).astype(f32)
    gate = hp[..., 3 * C_WIDTH:4 * C_WIDTH].astype(f32)
    beta_raw = hp[..., 4 * C_WIDTH:4 * C_WIDTH + C_HEADS].astype(f32)
    a_raw = hp[..., 4 * C_WIDTH + C_HEADS:].astype(f32)
    q = _l2norm(qkv[..., :C_WIDTH].reshape(bsz, s, C_HEADS, C_HEAD_DIM))
    k = _l2norm(qkv[..., C_WIDTH:2 * C_WIDTH].reshape(bsz, s, C_HEADS, C_HEAD_DIM))
    v = qkv[..., 2 * C_WIDTH:].reshape(bsz, s, C_HEADS, C_HEAD_DIM)
    beta = jax.nn.sigmoid(beta_raw)
    g = -jnp.exp(a_log.astype(f32)) * jax.nn.softplus(a_raw + dt_bias.astype(f32))
    o = _gated_delta_rule(q, k, v, g, beta)
    o = o * lax.rsqrt(jnp.mean(o * o, axis=-1, keepdims=True) + RMS_EPS) * norm_w.astype(f32)
    o = o.reshape(bsz, s, C_WIDTH) * jax.nn.silu(gate)
    return o.astype(hp.dtype)


def setup_inputs(seed: int = 0) -> dict:
    key = jax.random.key(seed)
    ks = jax.random.split(key, 32)
    f32 = jnp.float32

    def nrm(k, shape, scale):
        return jax.random.normal(k, shape, f32) * scale

    ev_in = 3 * A_WIDTH + S5_WIDTH
    od_in = 4 * C_WIDTH + 2 * C_HEADS
    dt_c = jnp.exp(jax.random.uniform(ks[20], (N_ODD, C_HEADS), f32, math.log(1e-3), math.log(1e-1)))
    return {
        'x': nrm(ks[0], (BATCH, SEQ, D_MODEL), 1.0),
        'rel_table': nrm(ks[1], (REL_BUCKETS, A_HEADS), 0.5),
        'ev_w_in': nrm(ks[2], (N_EVEN, D_MODEL, ev_in), D_MODEL ** -0.5),
        'ev_w_out': nrm(ks[3], (N_EVEN, A_WIDTH + S5_WIDTH, D_MODEL), (A_WIDTH + S5_WIDTH) ** -0.5 * DN_BETA),
        's5_lambda_re': -0.5 + nrm(ks[4], (N_EVEN, S5_GROUPS, S5_STATE), 0.01),
        's5_lambda_im': jnp.broadcast_to(jnp.pi * jnp.arange(S5_STATE, dtype=f32), (N_EVEN, S5_GROUPS, S5_STATE)),
        's5_b_re': nrm(ks[5], (N_EVEN, S5_GROUPS, S5_STATE, S5_GROUP), (2 * S5_GROUP) ** -0.5),
        's5_b_im': nrm(ks[6], (N_EVEN, S5_GROUPS, S5_STATE, S5_GROUP), (2 * S5_GROUP) ** -0.5),
        's5_c_re': nrm(ks[7], (N_EVEN, S5_GROUPS, S5_GROUP, S5_STATE), S5_STATE ** -0.5),
        's5_c_im': nrm(ks[8], (N_EVEN, S5_GROUPS, S5_GROUP, S5_STATE), S5_STATE ** -0.5),
        's5_d': nrm(ks[9], (N_EVEN, S5_WIDTH), 1.0),
        's5_log_dt': jax.random.uniform(ks[10], (N_EVEN, S5_GROUPS), f32, math.log(1e-3), math.log(1e-1)),
        's5_w_glu': nrm(ks[11], (N_EVEN, S5_WIDTH, S5_WIDTH), S5_WIDTH ** -0.5),
        's5_b_glu': nrm(ks[12], (N_EVEN, S5_WIDTH), 0.01),
        'od_w_in': nrm(ks[13], (N_ODD, D_MODEL, od_in), D_MODEL ** -0.5),
        'od_conv_w': nrm(ks[14], (N_ODD, C_CONV, 3 * C_WIDTH), C_CONV ** -0.5),
        'od_a_log': jnp.log(jax.random.uniform(ks[15], (N_ODD, C_HEADS), f32, 1.0, 16.0)),
        'od_dt_bias': dt_c + jnp.log(-jnp.expm1(-dt_c)),
        'od_norm_w': 1.0 + nrm(ks[16], (N_ODD, C_HEAD_DIM), 0.01),
        'od_w_out': nrm(ks[17], (N_ODD, C_WIDTH, D_MODEL), C_WIDTH ** -0.5 * DN_BETA),
        'ln_mix_g': 1.0 + nrm(ks[18], (DEPTH, D_MODEL), 0.01),
        'ln_mix_b': nrm(ks[19], (DEPTH, D_MODEL), 0.01),
        'mlp_w1': nrm(ks[21], (DEPTH, D_MODEL, D_FF), D_MODEL ** -0.5),
        'mlp_w2': nrm(ks[22], (DEPTH, D_FF, D_MODEL), D_FF ** -0.5 * DN_BETA),
        'ln_ffn_g': 1.0 + nrm(ks[23], (DEPTH, D_MODEL), 0.01),
        'ln_ffn_b': nrm(ks[24], (DEPTH, D_MODEL), 0.01),
    }


def reference(x, rel_table, ev_w_in, ev_w_out, s5_lambda_re, s5_lambda_im, s5_b_re, s5_b_im,
              s5_c_re, s5_c_im, s5_d, s5_log_dt, s5_w_glu, s5_b_glu, od_w_in, od_conv_w,
              od_a_log, od_dt_bias, od_norm_w, od_w_out, ln_mix_g, ln_mix_b, mlp_w1, mlp_w2,
              ln_ffn_g, ln_ffn_b):
    bsz, s, _ = x.shape
    for layer in range(DEPTH):
        i = layer // 2
        if layer % 2 == 0:
            hp = x @ ev_w_in[i]
            q = hp[..., :A_WIDTH].reshape(bsz, s, A_HEADS, A_HEAD_DIM)
            k = hp[..., A_WIDTH:2 * A_WIDTH].reshape(bsz, s, A_HEADS, A_HEAD_DIM)
            v = hp[..., 2 * A_WIDTH:3 * A_WIDTH].reshape(bsz, s, A_HEADS, A_HEAD_DIM)
            u = hp[..., 3 * A_WIDTH:]
            attn = _moba_attention(q, k, v, rel_table)
            ssm = _s5_mixer(u, s5_lambda_re[i], s5_lambda_im[i], s5_b_re[i], s5_b_im[i],
                            s5_c_re[i], s5_c_im[i], s5_d[i], s5_log_dt[i], s5_w_glu[i], s5_b_glu[i])
            mix = jnp.concatenate([attn, ssm.astype(attn.dtype)], axis=-1) @ ev_w_out[i]
        else:
            hp = x @ od_w_in[i]
            mix = _gdn_mixer(hp, od_conv_w[i], od_a_log[i], od_dt_bias[i], od_norm_w[i]) @ od_w_out[i]
        x = _layer_norm(DN_ALPHA * x + mix.astype(x.dtype), ln_mix_g[layer], ln_mix_b[layer])
        hid = jnp.square(jax.nn.relu(x @ mlp_w1[layer]))
        x = _layer_norm(DN_ALPHA * x + (hid @ mlp_w2[layer]).astype(x.dtype), ln_ffn_g[layer], ln_ffn_b[layer])
    return x
```

```cpp
#include <hip/hip_runtime.h>
#include <stdint.h>
#include <math.h>

constexpr int D = 1024, NB = 4, S = 4096, M = NB * S;
constexpr int AW = 512, AH = 8, AD = 64, MB = 256, NBLK = S / MB;
constexpr int SW = 512, SG = 16, NG = 32, SP = 64;
constexpr int CH = 8, CD = 128, CW = 1024, CCONV = 4;
constexpr int FF = 4096;
constexpr int EV_IN = 3 * AW + SW;
constexpr int OD_IN = 4 * CW + 2 * CH;
constexpr float DN_ALPHA = 1.41421356237f;
constexpr float LN_EPS = 1e-5f, RMS_EPS = 1e-6f, L2_EPS = 1e-6f;

template <int ACT>
__global__ __launch_bounds__(256) void k_gemm(const float* __restrict__ A, int lda, const float* __restrict__ B, int ldb,
                                               float* __restrict__ C, int ldc, int Mr, int N, int K) {
    __shared__ float As[16][68];
    __shared__ float Bs[16][68];
    const int bm = blockIdx.y * 64, bn = blockIdx.x * 64;
    const int tid = threadIdx.x, tx = tid & 15, ty = tid >> 4;
    float acc[4][4];
#pragma unroll
    for (int i = 0; i < 4; ++i)
#pragma unroll
        for (int j = 0; j < 4; ++j) acc[i][j] = 0.f;
    for (int k0 = 0; k0 < K; k0 += 16) {
        {
            const int r = tid >> 2, c = (tid & 3) * 4;
            const float4 v = *(const float4*)(A + (size_t)(bm + r) * lda + k0 + c);
            As[c][r] = v.x; As[c + 1][r] = v.y; As[c + 2][r] = v.z; As[c + 3][r] = v.w;
        }
        {
            const int r = tid >> 4, c = (tid & 15) * 4;
#pragma unroll
            for (int j = 0; j < 4; ++j) { const int n = bn + c + j; Bs[r][c + j] = (n < N) ? B[(size_t)(k0 + r) * ldb + n] : 0.f; }
        }
        __syncthreads();
#pragma unroll
        for (int kk = 0; kk < 16; ++kk) {
            float a[4], b[4];
#pragma unroll
            for (int i = 0; i < 4; ++i) a[i] = As[kk][ty * 4 + i];
#pragma unroll
            for (int j = 0; j < 4; ++j) b[j] = Bs[kk][tx * 4 + j];
#pragma unroll
            for (int i = 0; i < 4; ++i)
#pragma unroll
                for (int j = 0; j < 4; ++j) acc[i][j] = fmaf(a[i], b[j], acc[i][j]);
        }
        __syncthreads();
    }
#pragma unroll
    for (int i = 0; i < 4; ++i)
#pragma unroll
        for (int j = 0; j < 4; ++j) {
            const int n = bn + tx * 4 + j;
            if (n < N) { float v = acc[i][j]; if (ACT == 1) { v = v > 0.f ? v : 0.f; v = v * v; } C[(size_t)(bm + ty * 4 + i) * ldc + n] = v; }
        }
}

__device__ __forceinline__ float wave_sum(float v) {
#pragma unroll
    for (int o = 1; o < 64; o <<= 1) v += __shfl_xor(v, o);
    return v;
}

__global__ __launch_bounds__(256) void k_ln(const float* __restrict__ xin, const float* __restrict__ t, const float* __restrict__ g,
                                            const float* __restrict__ b, float* __restrict__ out, int rows) {
    const int row = blockIdx.x * 4 + (threadIdx.x >> 6), lane = threadIdx.x & 63;
    if (row >= rows) return;
    float v[16]; float s = 0.f;
#pragma unroll
    for (int j = 0; j < 16; ++j) { const int c = j * 64 + lane; v[j] = DN_ALPHA * xin[(size_t)row * D + c] + t[(size_t)row * D + c]; s += v[j]; }
    const float mu = wave_sum(s) * (1.f / D); float q = 0.f;
#pragma unroll
    for (int j = 0; j < 16; ++j) { v[j] -= mu; q += v[j] * v[j]; }
    const float rstd = rsqrtf(wave_sum(q) * (1.f / D) + LN_EPS);
#pragma unroll
    for (int j = 0; j < 16; ++j) { const int c = j * 64 + lane; out[(size_t)row * D + c] = v[j] * rstd * g[c] + b[c]; }
}

__global__ __launch_bounds__(64) void k_kmean(const float* __restrict__ hp, float* __restrict__ kmean) {
    const int n = blockIdx.x, h = blockIdx.y, d = threadIdx.x;
    float s = 0.f;
    for (int t = 0; t < MB; ++t) s += hp[(size_t)(n * MB + t) * EV_IN + AW + h * AD + d];
    kmean[(n * AH + h) * AD + d] = s * (1.f / MB);
}

__device__ __forceinline__ int t5_bucket(int n) {
    if (n < 16) return n;
    int l = 16 + (int)(logf((float)n / 16.f) / logf(8.f) * 16.f);
    return l < 31 ? l : 31;
}

__global__ __launch_bounds__(64) void k_attn_naive(const float* __restrict__ hp, const float* __restrict__ kmean,
                                                   const float* __restrict__ rel_table, float* __restrict__ cat) {
    __shared__ float biasl[256];
    const int h = blockIdx.y, s = blockIdx.x * 64 + threadIdx.x, blk = s / MB;
    for (int i = threadIdx.x; i < 256; i += 64) biasl[i] = rel_table[t5_bucket(i) * AH + h];
    __syncthreads();
    float q[64];
#pragma unroll
    for (int d = 0; d < 64; ++d) q[d] = hp[(size_t)s * EV_IN + h * AD + d] * 0.125f;
    float g0 = -3e38f, g1 = -3e38f, g2 = -3e38f; int i0 = -1, i1 = -1, i2 = -1;
    for (int n = 0; n < blk; ++n) {
        float gsum = 0.f;
#pragma unroll
        for (int d = 0; d < 64; ++d) gsum = fmaf(q[d], kmean[(n * AH + h) * AD + d], gsum);
        if (gsum > g0) { g2 = g1; i2 = i1; g1 = g0; i1 = i0; g0 = gsum; i0 = n; }
        else if (gsum > g1) { g2 = g1; i2 = i1; g1 = gsum; i1 = n; }
        else if (gsum > g2) { g2 = gsum; i2 = n; }
    }
    float mrun = -1e30f, l = 0.f; float acc[64];
#pragma unroll
    for (int d = 0; d < 64; ++d) acc[d] = 0.f;
    for (int part = 0; part < 4; ++part) {
        int kb, kend;
        if (part == 0) { kb = blk * MB; kend = s + 1; }
        else { const int sel = part == 1 ? i0 : (part == 2 ? i1 : i2); if (sel < 0) continue; kb = sel * MB; kend = kb + MB; }
        for (int j = kb; j < kend; ++j) {
            const float* kr = hp + (size_t)j * EV_IN + AW + h * AD;
            const float* vr = hp + (size_t)j * EV_IN + 2 * AW + h * AD;
            float dot = 0.f;
#pragma unroll
            for (int d = 0; d < 64; ++d) dot = fmaf(q[d], kr[d], dot);
            const int dist = s - j;
            dot += dist < 256 ? biasl[dist] : biasl[255];
            if (dot > mrun) { const float f = __expf(mrun - dot); l *= f;
#pragma unroll
                for (int d = 0; d < 64; ++d) acc[d] *= f;
                mrun = dot; }
            const float p = __expf(dot - mrun); l += p;
#pragma unroll
            for (int d = 0; d < 64; ++d) acc[d] = fmaf(p, vr[d], acc[d]);
        }
    }
    const float il = 1.f / l;
#pragma unroll
    for (int d = 0; d < 64; ++d) cat[(size_t)s * D + h * AD + d] = acc[d] * il;
}

__device__ __forceinline__ float gelu_tanh(float x) { const float c = 0.7978845608028654f; const float t = tanhf(c * (x + 0.044715f * x * x * x)); return 0.5f * x * (1.f + t); }
__device__ __forceinline__ float sigmoidf(float x) { return 1.f / (1.f + __expf(-x)); }

__global__ __launch_bounds__(64) void k_s5_naive(const float* __restrict__ hp, const float* __restrict__ lam_re, const float* __restrict__ lam_im,
                                                 const float* __restrict__ b_re, const float* __restrict__ b_im, const float* __restrict__ c_re,
                                                 const float* __restrict__ c_im, const float* __restrict__ d_skip, const float* __restrict__ log_dt,
                                                 float* __restrict__ G) {
    __shared__ float hs[128];
    const int g = blockIdx.x, p = threadIdx.x, lane = threadIdx.x;
    const float lr = fminf(lam_re[g * SP + p], -1e-4f), li = lam_im[g * SP + p], dt = expf(log_dt[g]);
    const float mag = expf(lr * dt), ar = mag * cosf(li * dt), ai = mag * sinf(li * dt);
    const float den = lr * lr + li * li;
    const float cr = ((ar - 1.f) * lr + ai * li) / den, ci = (ai * lr - (ar - 1.f) * li) / den;
    float bbr[16], bbi[16];
#pragma unroll
    for (int j = 0; j < 16; ++j) { const float br = b_re[(g * SP + p) * SG + j], bi = b_im[(g * SP + p) * SG + j]; bbr[j] = cr * br - ci * bi; bbi[j] = cr * bi + ci * br; }
    const int oi = lane & 15, q4 = lane >> 4;
    float ccr[16], cci[16];
#pragma unroll
    for (int pp = 0; pp < 16; ++pp) { ccr[pp] = c_re[(g * SG + oi) * SP + q4 * 16 + pp]; cci[pp] = c_im[(g * SG + oi) * SP + q4 * 16 + pp]; }
    const float dsk = d_skip[g * SG + oi];
    float hr = 0.f, hi = 0.f;
    for (int t = 0; t < S; ++t) {
        const float* ur = hp + (size_t)t * EV_IN + 3 * AW + g * SG;
        float xr = 0.f, xi = 0.f;
#pragma unroll
        for (int j = 0; j < 16; ++j) { const float u = ur[j]; xr = fmaf(bbr[j], u, xr); xi = fmaf(bbi[j], u, xi); }
        const float nr = ar * hr - ai * hi + xr, ni = ar * hi + ai * hr + xi;
        hr = nr; hi = ni;
        __syncthreads();
        hs[p] = hr; hs[64 + p] = hi;
        __syncthreads();
        float y = 0.f;
#pragma unroll
        for (int pp = 0; pp < 16; ++pp) y += ccr[pp] * hs[q4 * 16 + pp] - cci[pp] * hs[64 + q4 * 16 + pp];
        y += __shfl_xor(y, 16); y += __shfl_xor(y, 32);
        if (q4 == 0) { y += dsk * ur[oi]; G[(size_t)t * SW + g * SG + oi] = gelu_tanh(y); }
    }
}

__global__ __launch_bounds__(256) void k_glu_fin(const float* __restrict__ G, const float* __restrict__ T2, const float* __restrict__ bglu, float* __restrict__ cat) {
    const int idx = blockIdx.x * 256 + threadIdx.x; const int t = idx / SW, c = idx % SW;
    cat[(size_t)t * D + AW + c] = G[idx] * sigmoidf(T2[idx] + bglu[c]);
}

__global__ __launch_bounds__(256) void k_gdn_conv(const float* __restrict__ hp, const float* __restrict__ cw, float* __restrict__ qkv) {
    const int idx = blockIdx.x * 256 + threadIdx.x; const int t = idx / (3 * CW), c = idx % (3 * CW);
    float a = 0.f;
#pragma unroll
    for (int i = 0; i < CCONV; ++i) { const int tt = t - 3 + i; if (tt >= 0) a = fmaf(cw[i * 3 * CW + c], hp[(size_t)tt * OD_IN + c], a); }
    qkv[idx] = a * sigmoidf(a);
}
__global__ __launch_bounds__(256) void k_gdn_l2(float* __restrict__ qkv) {
    const int w = blockIdx.x * 4 + (threadIdx.x >> 6), lane = threadIdx.x & 63; const int t = w / 16, j = w % 16;
    float* p = qkv + (size_t)t * 3 * CW + j * CD;
    const float a = p[lane], b = p[lane + 64];
    const float ss = wave_sum(a * a + b * b); const float r = rsqrtf(ss + L2_EPS);
    p[lane] = a * r; p[lane + 64] = b * r;
}
__global__ __launch_bounds__(256) void k_gdn_gates(const float* __restrict__ hp, const float* __restrict__ a_log, const float* __restrict__ dt_bias,
                                                   float* __restrict__ beta, float* __restrict__ gd) {
    const int idx = blockIdx.x * 256 + threadIdx.x; const int t = idx / CH, h = idx % CH;
    beta[idx] = sigmoidf(hp[(size_t)t * OD_IN + 4 * CW + h]);
    const float x = hp[(size_t)t * OD_IN + 4 * CW + CH + h] + dt_bias[h];
    const float sp = x > 20.f ? x : log1pf(expf(x));
    gd[idx] = -expf(a_log[h]) * sp;
}
__global__ __launch_bounds__(128) void k_gdn_naive(const float* __restrict__ qkv, const float* __restrict__ beta, const float* __restrict__ gd, float* __restrict__ o) {
    __shared__ float ks[128], qs[128];
    const int h = blockIdx.x, e = threadIdx.x;
    float St[128];
#pragma unroll
    for (int d = 0; d < 128; ++d) St[d] = 0.f;
    const float scale = 0.08838834764831845f;
    for (int t = 0; t < S; ++t) {
        const float* row = qkv + (size_t)t * 3 * CW;
        __syncthreads();
        qs[e] = row[h * CD + e]; ks[e] = row[CW + h * CD + e];
        __syncthreads();
        const float v = row[2 * CW + h * CD + e], bt = beta[t * CH + h], eg = expf(gd[t * CH + h]);
        float pred = 0.f;
#pragma unroll
        for (int d = 0; d < 128; ++d) { St[d] *= eg; pred = fmaf(St[d], ks[d], pred); }
        const float vn = bt * (v - pred); float ov = 0.f;
#pragma unroll
        for (int d = 0; d < 128; ++d) { St[d] = fmaf(ks[d], vn, St[d]); ov = fmaf(St[d], qs[d], ov); }
        o[(size_t)t * CW + h * CD + e] = ov * scale;
    }
}
__global__ __launch_bounds__(256) void k_gdn_post(const float* __restrict__ o, const float* __restrict__ hp, const float* __restrict__ nw, float* __restrict__ cat) {
    const int w = blockIdx.x * 4 + (threadIdx.x >> 6), lane = threadIdx.x & 63; const int t = w / CH, h = w % CH;
    const float* p = o + (size_t)t * CW + h * CD;
    const float a = p[lane], b = p[lane + 64];
    const float ms = wave_sum(a * a + b * b) * (1.f / CD); const float r = rsqrtf(ms + RMS_EPS);
    const float ga = hp[(size_t)t * OD_IN + 3 * CW + h * CD + lane], gb = hp[(size_t)t * OD_IN + 3 * CW + h * CD + lane + 64];
    cat[(size_t)t * CW + h * CD + lane] = a * r * nw[lane] * (ga * sigmoidf(ga));
    cat[(size_t)t * CW + h * CD + lane + 64] = b * r * nw[lane + 64] * (gb * sigmoidf(gb));
}

template <int ACT>
static void gemm(hipStream_t st, const float* A, int lda, const float* B, int ldb, float* C, int ldc, int Mr, int N, int K) {
    dim3 grid((N + 63) / 64, Mr / 64);
    hipLaunchKernelGGL(k_gemm<ACT>, grid, dim3(256), 0, st, A, lda, B, ldb, C, ldc, Mr, N, K);
}

extern "C" void kernel_launch(void* const* d_in, const int* in_sizes, int n_in, void* d_out, int out_size, void* d_ws, size_t ws_size, hipStream_t stream) {
    const float* x = (const float*)d_in[0];
    const float* rel_table = (const float*)d_in[1];
    const float* ev_w_in = (const float*)d_in[2];
    const float* ev_w_out = (const float*)d_in[3];
    const float* lam_re = (const float*)d_in[4];
    const float* lam_im = (const float*)d_in[5];
    const float* b_re = (const float*)d_in[6];
    const float* b_im = (const float*)d_in[7];
    const float* c_re = (const float*)d_in[8];
    const float* c_im = (const float*)d_in[9];
    const float* s5_d = (const float*)d_in[10];
    const float* log_dt = (const float*)d_in[11];
    const float* w_glu = (const float*)d_in[12];
    const float* b_glu = (const float*)d_in[13];
    const float* od_w_in = (const float*)d_in[14];
    const float* conv_w = (const float*)d_in[15];
    const float* a_log = (const float*)d_in[16];
    const float* dt_bias = (const float*)d_in[17];
    const float* norm_w = (const float*)d_in[18];
    const float* od_w_out = (const float*)d_in[19];
    const float* ln_mix_g = (const float*)d_in[20];
    const float* ln_mix_b = (const float*)d_in[21];
    const float* mlp_w1 = (const float*)d_in[22];
    const float* mlp_w2 = (const float*)d_in[23];
    const float* ln_ffn_g = (const float*)d_in[24];
    const float* ln_ffn_b = (const float*)d_in[25];
    float* out = (float*)d_out;
    float* ws = (float*)d_ws;
    const size_t MiF = 1u << 18;
    float* XB = ws;
    float* HP = ws + 64 * MiF;
    float* CAT = ws + 130 * MiF;
    float* T = ws + 146 * MiF;
    float* QKV = ws + 162 * MiF;
    float* OB = ws + 210 * MiF;
    float* SMALL = ws + 226 * MiF;
    float* XA = out;
    for (int layer = 0; layer < 2; ++layer) {
        const float* xin = layer == 0 ? x : XB;
        float* xout = layer == 0 ? XB : out;
        for (int b = 0; b < NB; ++b) {
            const float* xb = xin + (size_t)b * S * D;
            float* xa = XA + (size_t)b * S * D;
            if (layer == 0) {
                gemm<0>(stream, xb, D, ev_w_in, EV_IN, HP, EV_IN, S, EV_IN, D);
                float* kmean = SMALL;
                hipLaunchKernelGGL(k_kmean, dim3(NBLK, AH), dim3(64), 0, stream, HP, kmean);
                hipLaunchKernelGGL(k_attn_naive, dim3(S / 64, AH), dim3(64), 0, stream, HP, kmean, rel_table, CAT);
                float* G = QKV; float* T2 = QKV + (size_t)S * SW;
                hipLaunchKernelGGL(k_s5_naive, dim3(NG), dim3(64), 0, stream, HP, lam_re, lam_im, b_re, b_im, c_re, c_im, s5_d, log_dt, G);
                gemm<0>(stream, G, SW, w_glu, SW, T2, SW, S, SW, SW);
                hipLaunchKernelGGL(k_glu_fin, dim3(S * SW / 256), dim3(256), 0, stream, G, T2, b_glu, CAT);
                gemm<0>(stream, CAT, D, ev_w_out, D, T, D, S, D, D);
            } else {
                gemm<0>(stream, xb, D, od_w_in, OD_IN, HP, OD_IN, S, OD_IN, D);
                hipLaunchKernelGGL(k_gdn_conv, dim3(S * 3 * CW / 256), dim3(256), 0, stream, HP, conv_w, QKV);
                hipLaunchKernelGGL(k_gdn_l2, dim3(S * 16 / 4), dim3(256), 0, stream, QKV);
                float* beta = SMALL; float* gd = SMALL + S * CH;
                hipLaunchKernelGGL(k_gdn_gates, dim3(S * CH / 256), dim3(256), 0, stream, HP, a_log, dt_bias, beta, gd);
                hipLaunchKernelGGL(k_gdn_naive, dim3(CH), dim3(128), 0, stream, QKV, beta, gd, OB);
                hipLaunchKernelGGL(k_gdn_post, dim3(S * CH / 4), dim3(256), 0, stream, OB, HP, norm_w, CAT);
                gemm<0>(stream, CAT, D, od_w_out, D, T, D, S, D, D);
            }
            hipLaunchKernelGGL(k_ln, dim3(S / 4), dim3(256), 0, stream, xb, T, ln_mix_g + layer * D, ln_mix_b + layer * D, xa, S);
            gemm<1>(stream, xa, D, mlp_w1 + (size_t)layer * D * FF, FF, HP, FF, S, FF, D);
            gemm<0>(stream, HP, FF, mlp_w2 + (size_t)layer * FF * D, D, T, D, S, D, FF);
            hipLaunchKernelGGL(k_ln, dim3(S / 4), dim3(256), 0, stream, xa, T, ln_ffn_g + layer * D, ln_ffn_b + layer * D, xout + (size_t)b * S * D, S);
        }
    }
}
```
